# Optimizing an MI355X kernel written in HIP

```python
import math
import jax, jax.numpy as jnp
from jax import lax
import numpy as np

D_MODEL = 1024
BATCH = 16
SEQ = 2048
DEPTH = 1

ATTN_HEADS = 8
KV_HEADS = 2
Q_PER_KV = ATTN_HEADS // KV_HEADS
HEAD_DIM = 64
D_ATTN = ATTN_HEADS * HEAD_DIM
D_KV = KV_HEADS * HEAD_DIM
WINDOW = 128
BLOCK = 128
NUM_BUCKETS = 32
MAX_DISTANCE = 128
D_SSM = 512
SSM_GROUP = 16
N_SSM_GROUPS = D_SSM // SSM_GROUP
SSM_STATE = 64
N_DIRS = 2
N_BRANCHES = 2
EPS = 1e-6
NEG_INF = -1e30
D_IN = D_ATTN + 2 * D_KV + D_ATTN + 2 * D_SSM + N_BRANCHES * D_MODEL
SPLITS = (D_ATTN,
          D_ATTN + D_KV,
          D_ATTN + 2 * D_KV,
          2 * D_ATTN + 2 * D_KV,
          2 * D_ATTN + 2 * D_KV + D_SSM,
          2 * D_ATTN + 2 * D_KV + 2 * D_SSM)

kernel_name = "hybrid_gated_swa_s5_block"


def rms_norm(x, g):
    x32 = x.astype(jnp.float32)
    y = x32 * lax.rsqrt(jnp.mean(x32 * x32, axis=-1, keepdims=True) + EPS)
    return (y * g.astype(jnp.float32)).astype(x.dtype)


def t5_bucket(rel):
    half = NUM_BUCKETS // 2
    ret = (rel > 0).astype(jnp.int32) * half
    n = jnp.abs(rel)
    max_exact = half // 2
    nf = jnp.maximum(n, 1).astype(jnp.float32)
    large = max_exact + (jnp.log(nf / max_exact) / math.log(MAX_DISTANCE / max_exact)
                         * (half - max_exact)).astype(jnp.int32)
    large = jnp.minimum(large, half - 1)
    return ret + jnp.where(n < max_exact, n, large)


def band_windows(t, nb):
    b = t.shape[0]
    tp = jnp.pad(t, ((0, 0), (BLOCK, BLOCK), (0, 0), (0, 0)))
    tb = tp.reshape(b, nb + 2, BLOCK, KV_HEADS, HEAD_DIM)
    return jnp.concatenate([tb[:, :-2], tb[:, 1:-1], tb[:, 2:]], axis=2)


def windowed_gqa(q, k, v, sink, rel_table):
    b, s, _ = q.shape
    nb = s // BLOCK
    q = q.reshape(b, nb, BLOCK, KV_HEADS, Q_PER_KV, HEAD_DIM)
    kw = band_windows(k.reshape(b, s, KV_HEADS, HEAD_DIM), nb)
    vw = band_windows(v.reshape(b, s, KV_HEADS, HEAD_DIM), nb)
    scores = jnp.einsum('bnqhgd,bnkhd->bnhgqk', q, kw).astype(jnp.float32) * (HEAD_DIM ** -0.5)
    rel = (jnp.arange(3 * BLOCK)[None, :] - BLOCK) - jnp.arange(BLOCK)[:, None]
    bias = rel_table.astype(jnp.float32)[t5_bucket(rel)]
    bias = jnp.transpose(bias, (2, 0, 1)).reshape(KV_HEADS, Q_PER_KV, BLOCK, 3 * BLOCK)
    kpos = jnp.arange(nb)[:, None] * BLOCK - BLOCK + jnp.arange(3 * BLOCK)[None, :]
    valid = (jnp.abs(rel) <= WINDOW)[None] & ((kpos >= 0) & (kpos < s))[:, None, :]
    scores = jnp.where(valid[None, :, None, None], scores + bias, NEG_INF)
    sk = sink.astype(jnp.float32).reshape(KV_HEADS, Q_PER_KV)[None, None, :, :, None, None]
    m = jnp.maximum(scores.max(axis=-1, keepdims=True), sk)
    p = jnp.exp(scores - m)
    probs = p / (p.sum(axis=-1, keepdims=True) + jnp.exp(sk - m))
    o = jnp.einsum('bnhgqk,bnkhd->bnqhgd', probs.astype(v.dtype), vw)
    return o.reshape(b, s, D_ATTN)


def _scan_op(e1, e2):
    a1, b1 = e1
    a2, b2 = e2
    return a1 * a2, a2 * b1 + b2


def s5_bidirectional(u, a_re, a_im, log_dt, b_re, b_im, c_re, c_im, d_skip):
    bsz, s, _ = u.shape
    f32 = jnp.float32
    ut = jnp.swapaxes(u.astype(f32).reshape(bsz, s, N_SSM_GROUPS, SSM_GROUP), 0, 1)
    y = ut * d_skip.astype(f32).reshape(N_SSM_GROUPS, SSM_GROUP)
    for d in range(N_DIRS):
        lam = lax.complex(a_re[d].astype(f32), a_im[d].astype(f32))
        dt = jnp.exp(log_dt[d].astype(f32))[:, None]
        a_bar = jnp.exp(lam * dt)
        coef = (a_bar - 1.0) / lam
        b_bar = lax.complex(b_re[d].astype(f32), b_im[d].astype(f32)) * coef[..., None]
        bu = lax.complex(jnp.einsum('sbgc,gpc->sbgp', ut, jnp.real(b_bar)),
                         jnp.einsum('sbgc,gpc->sbgp', ut, jnp.imag(b_bar)))
        a_el = jnp.broadcast_to(a_bar[None, None], (s, 1, N_SSM_GROUPS, SSM_STATE))
        _, xs = lax.associative_scan(_scan_op, (a_el, bu), reverse=(d == 1), axis=0)
        y = y + jnp.einsum('sbgp,gcp->sbgc', jnp.real(xs), c_re[d].astype(f32)) \
              - jnp.einsum('sbgp,gcp->sbgc', jnp.imag(xs), c_im[d].astype(f32))
    return jnp.swapaxes(y, 0, 1).reshape(bsz, s, D_SSM)


def setup_inputs(seed: int = 0) -> dict:
    key = jax.random.key(seed)
    ks = jax.random.split(key, 24)
    nrm = lambda k, shape, scale: jax.random.normal(k, shape, jnp.float32) * scale
    L, G, P, C = DEPTH, N_SSM_GROUPS, SSM_STATE, SSM_GROUP
    a_im_init = math.pi * jnp.arange(P, dtype=jnp.float32)
    return {
        "x": nrm(ks[0], (BATCH, SEQ, D_MODEL), 1.0),
        "norm_gain": 1.0 + nrm(ks[1], (L, D_MODEL), 0.02),
        "w_in": nrm(ks[2], (L, D_MODEL, D_IN), D_MODEL ** -0.5),
        "b_gate": nrm(ks[3], (L, N_BRANCHES * D_MODEL), 0.02),
        "attn_sink": nrm(ks[4], (L, ATTN_HEADS), 0.5),
        "rel_bias_table": nrm(ks[5], (NUM_BUCKETS, ATTN_HEADS), 0.5),
        "ssm_a_re": -0.5 + nrm(ks[6], (L, N_DIRS, G, P), 0.01),
        "ssm_a_im": a_im_init + nrm(ks[7], (L, N_DIRS, G, P), 0.01),
        "ssm_log_dt": jax.random.uniform(ks[8], (L, N_DIRS, G), jnp.float32,
                                         math.log(1e-3), math.log(1e-1)),
        "ssm_b_re": nrm(ks[9], (L, N_DIRS, G, P, C), (2 * C) ** -0.5),
        "ssm_b_im": nrm(ks[10], (L, N_DIRS, G, P, C), (2 * C) ** -0.5),
        "ssm_c_re": nrm(ks[11], (L, N_DIRS, G, C, P), (2 * P) ** -0.5),
        "ssm_c_im": nrm(ks[12], (L, N_DIRS, G, C, P), (2 * P) ** -0.5),
        "ssm_d": nrm(ks[13], (L, D_SSM), 1.0),
        "w_glu": nrm(ks[14], (L, D_SSM, D_SSM), D_SSM ** -0.5),
        "b_glu": nrm(ks[15], (L, D_SSM), 0.02),
        "w_branch_attn": nrm(ks[16], (L, D_ATTN, D_MODEL), D_ATTN ** -0.5),
        "w_branch_ssm": nrm(ks[17], (L, D_SSM, D_MODEL), D_SSM ** -0.5),
        "w_out": nrm(ks[18], (L, D_MODEL, D_MODEL), D_MODEL ** -0.5),
        "final_norm_gain": 1.0 + nrm(ks[19], (D_MODEL,), 0.02),
    }


def reference(x, norm_gain, w_in, b_gate, attn_sink, rel_bias_table, ssm_a_re, ssm_a_im,
              ssm_log_dt, ssm_b_re, ssm_b_im, ssm_c_re, ssm_c_im, ssm_d, w_glu, b_glu,
              w_branch_attn, w_branch_ssm, w_out, final_norm_gain):
    for l in range(DEPTH):
        h = rms_norm(x, norm_gain[l])
        proj = jnp.einsum('bsd,de->bse', h, w_in[l])
        q, k, v, z_attn, u_ssm, z_ssm, g = jnp.split(proj, SPLITS, axis=-1)
        g_attn, g_ssm = jnp.split(g + b_gate[l], N_BRANCHES, axis=-1)
        attn = windowed_gqa(q, k, v, attn_sink[l], rel_bias_table) * jax.nn.silu(z_attn)
        y = s5_bidirectional(u_ssm, ssm_a_re[l], ssm_a_im[l], ssm_log_dt[l], ssm_b_re[l],
                             ssm_b_im[l], ssm_c_re[l], ssm_c_im[l], ssm_d[l]).astype(x.dtype)
        y = jax.nn.gelu(y)
        y = y * jax.nn.sigmoid(jnp.einsum('bsc,ce->bse', y, w_glu[l]) + b_glu[l])
        ssm = y * jax.nn.silu(z_ssm)
        merged = jax.nn.sigmoid(g_attn) * jnp.einsum('bsc,cd->bsd', attn, w_branch_attn[l]) \
               + jax.nn.sigmoid(g_ssm) * jnp.einsum('bsc,cd->bsd', ssm, w_branch_ssm[l])
        x = x + jnp.einsum('bsd,de->bse', merged, w_out[l])
    return rms_norm(x, final_norm_gain)
```

```cpp
#include <hip/hip_runtime.h>
#include <math.h>

namespace nv {
constexpr int D = 1024, NB = 16, S = 2048, DIN = 4352;
constexpr int DA = 512, DKV = 128, DS = 512, G = 32, C = 16, P = 64;
constexpr int OQ = 0, OK_ = 512, OV = 640, OZA = 768, OU = 1280, OZS = 1792, OG = 2304;

__device__ __forceinline__ float sigm(float v) { return 1.f / (1.f + expf(-v)); }
__device__ __forceinline__ float silu(float v) { return v * sigm(v); }
__device__ __forceinline__ float gelu_tanh(float v) { return 0.5f * v * (1.f + tanhf(0.7978845608028654f * (v + 0.044715f * v * v * v))); }

__global__ void rstd_kernel(const float* x, float* rstd, int rows) {
    const int w = (blockIdx.x * blockDim.x + threadIdx.x) >> 6, lane = threadIdx.x & 63;
    if (w >= rows) return;
    const float* r = x + (size_t)w * D; float s = 0.f;
    for (int i = lane; i < D; i += 64) s += r[i] * r[i];
    for (int o = 32; o; o >>= 1) s += __shfl_xor(s, o);
    if (lane == 0) rstd[w] = 1.0f / sqrtf(s / D + 1e-6f);
}

__global__ void __launch_bounds__(256) gemm_kernel(const float* A, int lda, const float* Bm, int ldb, float* Cm, int ldc, int M, int N, int K, const float* rs, const float* ks) {
    __shared__ float As[16][65], Bs[16][65];
    const int tx = threadIdx.x & 15, ty = threadIdx.x >> 4, m0 = blockIdx.y * 64, n0 = blockIdx.x * 64;
    float acc[4][4] = {};
    for (int k0 = 0; k0 < K; k0 += 16) {
        for (int i = threadIdx.x; i < 64 * 16; i += 256) { const int m = i >> 4, k = i & 15; float v = A[(size_t)(m0 + m) * lda + k0 + k]; if (rs) v *= rs[m0 + m]; if (ks) v *= ks[k0 + k]; As[k][m] = v; }
        for (int i = threadIdx.x; i < 64 * 16; i += 256) { const int k = i >> 6, n = i & 63; Bs[k][n] = Bm[(size_t)(k0 + k) * ldb + n0 + n]; }
        __syncthreads();
#pragma unroll
        for (int k = 0; k < 16; ++k) { float a[4], b[4];
#pragma unroll
            for (int i = 0; i < 4; ++i) { a[i] = As[k][ty * 4 + i]; b[i] = Bs[k][tx * 4 + i]; }
#pragma unroll
            for (int i = 0; i < 4; ++i)
#pragma unroll
                for (int j = 0; j < 4; ++j) acc[i][j] += a[i] * b[j]; }
        __syncthreads();
    }
#pragma unroll
    for (int i = 0; i < 4; ++i)
#pragma unroll
        for (int j = 0; j < 4; ++j) Cm[(size_t)(m0 + ty * 4 + i) * ldc + n0 + tx * 4 + j] = acc[i][j];
}

__device__ __forceinline__ int t5_bucket(int rel) {
    const int n = rel < 0 ? -rel : rel; int b = rel > 0 ? 16 : 0;
    if (n < 8) return b + n;
    const int e = 31 - __clz(n) - 3, base = 8 << e; int large = 8 + 2 * e + ((n * n >= 2 * base * base) ? 1 : 0);
    if (large > 15) large = 15;
    return b + large;
}

__global__ void __launch_bounds__(64) attn_kernel(const float* proj, const float* sink, const float* rel_table, float* A1) {
    const int idx = blockIdx.x * blockDim.x + threadIdx.x; if (idx >= S * 8) return;
    const int h = idx / S, s = idx % S, kvh = h >> 2;
    const float* qp = proj + (size_t)s * DIN + OQ + h * 64;
    float q[64];
#pragma unroll
    for (int d = 0; d < 64; ++d) q[d] = qp[d];
    float m = sink[h], l = 1.f; float o[64];
#pragma unroll
    for (int d = 0; d < 64; ++d) o[d] = 0.f;
    for (int rel = -128; rel <= 128; ++rel) { const int kp = s + rel; if (kp < 0 || kp >= S) continue;
        const float* kr = proj + (size_t)kp * DIN + OK_ + kvh * 64; const float* vr = proj + (size_t)kp * DIN + OV + kvh * 64;
        float sc = 0.f;
#pragma unroll
        for (int d = 0; d < 64; ++d) sc += q[d] * kr[d];
        sc = sc * 0.125f + rel_table[t5_bucket(rel) * 8 + h];
        const float mn = fmaxf(m, sc), al = expf(m - mn), p = expf(sc - mn);
        l = l * al + p;
#pragma unroll
        for (int d = 0; d < 64; ++d) o[d] = o[d] * al + p * vr[d];
        m = mn; }
    const float inv = 1.f / l; const float* z = proj + (size_t)s * DIN + OZA + h * 64;
#pragma unroll
    for (int d = 0; d < 64; ++d) A1[(size_t)s * DA + h * 64 + d] = o[d] * inv * silu(z[d]);
}

__global__ void __launch_bounds__(64) ssm_kernel(const float* proj, const float* a_re, const float* a_im, const float* log_dt, const float* b_re, const float* b_im,
                                                 const float* c_re, const float* c_im, const float* dsk, float* Y) {
    const int g = blockIdx.x, p = threadIdx.x;
    for (int d = 0; d < 2; ++d) {
        const float lr = a_re[(d * G + g) * P + p], li = a_im[(d * G + g) * P + p], dt = expf(log_dt[d * G + g]);
        const float mag = expf(lr * dt), ar = mag * cosf(li * dt), ai = mag * sinf(li * dt);
        const float nr = ar - 1.f, ni = ai, den = lr * lr + li * li; const float cr = (nr * lr + ni * li) / den, ci = (ni * lr - nr * li) / den;
        float br[16], bi[16], cre[16], cim[16];
#pragma unroll
        for (int c = 0; c < 16; ++c) { const float x = b_re[((d * G + g) * P + p) * C + c], y = b_im[((d * G + g) * P + p) * C + c]; br[c] = x * cr - y * ci; bi[c] = x * ci + y * cr;
            cre[c] = c_re[((d * G + g) * C + c) * P + p]; cim[c] = c_im[((d * G + g) * C + c) * P + p]; }
        float xr = 0.f, xi = 0.f;
        for (int step = 0; step < S; ++step) { const int s = d == 0 ? step : S - 1 - step;
            const float* u = proj + (size_t)s * DIN + OU + g * 16;
            float ur = 0.f, ui = 0.f; float uv[16];
#pragma unroll
            for (int c = 0; c < 16; ++c) { uv[c] = u[c]; ur += uv[c] * br[c]; ui += uv[c] * bi[c]; }
            const float tr = ar * xr - ai * xi + ur, ti = ar * xi + ai * xr + ui; xr = tr; xi = ti;
#pragma unroll
            for (int c = 0; c < 16; ++c) { float v = xr * cre[c] - xi * cim[c];
                for (int o = 32; o; o >>= 1) v += __shfl_xor(v, o);
                if (p == c) { float* yp = Y + (size_t)s * DS + g * 16 + c; if (d == 0) *yp = dsk[g * 16 + c] * uv[c] + v; else *yp = gelu_tanh(*yp + v); } }
        }
    }
}

__global__ void glu_kernel(const float* Yg, const float* Gm, const float* b_glu, const float* proj, float* A2) {
    const int i = blockIdx.x * blockDim.x + threadIdx.x; if (i >= S * DS) return; const int s = i / DS, c = i % DS;
    A2[i] = Yg[i] * sigm(Gm[i] + b_glu[c]) * silu(proj[(size_t)s * DIN + OZS + c]);
}
__global__ void merge_kernel(const float* PA, const float* PS, const float* proj, const float* b_gate, float* Mg) {
    const int i = blockIdx.x * blockDim.x + threadIdx.x; if (i >= S * D) return; const int s = i / D, c = i % D;
    const float ga = proj[(size_t)s * DIN + OG + c] + b_gate[c], gs = proj[(size_t)s * DIN + OG + D + c] + b_gate[D + c];
    Mg[i] = sigm(ga) * PA[i] + sigm(gs) * PS[i];
}
__global__ void final_kernel(const float* x, const float* O, const float* gain, float* out) {
    const int w = (blockIdx.x * blockDim.x + threadIdx.x) >> 6, lane = threadIdx.x & 63; if (w >= S) return;
    float v[16]; float s = 0.f;
#pragma unroll
    for (int i = 0; i < 16; ++i) { const int c = lane + 64 * i; v[i] = x[(size_t)w * D + c] + O[(size_t)w * D + c]; s += v[i] * v[i]; }
    for (int o = 32; o; o >>= 1) s += __shfl_xor(s, o);
    const float r = 1.0f / sqrtf(s / D + 1e-6f);
#pragma unroll
    for (int i = 0; i < 16; ++i) { const int c = lane + 64 * i; out[(size_t)w * D + c] = v[i] * r * gain[c]; }
}
}

extern "C" void kernel_launch(void* const* d_in, const int* in_sizes, int n_in, void* d_out, int out_size, void* d_ws, size_t ws_size, hipStream_t stream) {
    using namespace nv;
    const float* x = (const float*)d_in[0]; const float* norm_gain = (const float*)d_in[1]; const float* w_in = (const float*)d_in[2]; const float* b_gate = (const float*)d_in[3];
    const float* sink = (const float*)d_in[4]; const float* rel_table = (const float*)d_in[5]; const float* a_re = (const float*)d_in[6]; const float* a_im = (const float*)d_in[7];
    const float* log_dt = (const float*)d_in[8]; const float* b_re = (const float*)d_in[9]; const float* b_im = (const float*)d_in[10]; const float* c_re = (const float*)d_in[11];
    const float* c_im = (const float*)d_in[12]; const float* dsk = (const float*)d_in[13]; const float* w_glu = (const float*)d_in[14]; const float* b_glu = (const float*)d_in[15];
    const float* w_ba = (const float*)d_in[16]; const float* w_bs = (const float*)d_in[17]; const float* w_out = (const float*)d_in[18]; const float* fgain = (const float*)d_in[19];
    float* out = (float*)d_out; float* ws = (float*)d_ws;
    float* rstd = ws; float* proj = rstd + S; float* A1 = proj + (size_t)S * DIN; float* Yg = A1 + (size_t)S * DA; float* Gm = Yg + (size_t)S * DS; float* A2 = Gm + (size_t)S * DS;
    float* PA = A2 + (size_t)S * DS; float* PS = PA + (size_t)S * D; float* Mg = PS + (size_t)S * D; float* O = Mg + (size_t)S * D;
    for (int b = 0; b < NB; ++b) {
        const float* xb = x + (size_t)b * S * D; float* ob = out + (size_t)b * S * D;
        rstd_kernel<<<S / 4, 256, 0, stream>>>(xb, rstd, S);
        gemm_kernel<<<dim3(DIN / 64, S / 64), 256, 0, stream>>>(xb, D, w_in, DIN, proj, DIN, S, DIN, D, rstd, norm_gain);
        attn_kernel<<<S * 8 / 64, 64, 0, stream>>>(proj, sink, rel_table, A1);
        ssm_kernel<<<G, 64, 0, stream>>>(proj, a_re, a_im, log_dt, b_re, b_im, c_re, c_im, dsk, Yg);
        gemm_kernel<<<dim3(DS / 64, S / 64), 256, 0, stream>>>(Yg, DS, w_glu, DS, Gm, DS, S, DS, DS, nullptr, nullptr);
        glu_kernel<<<S * DS / 256, 256, 0, stream>>>(Yg, Gm, b_glu, proj, A2);
        gemm_kernel<<<dim3(D / 64, S / 64), 256, 0, stream>>>(A1, DA, w_ba, D, PA, D, S, D, DA, nullptr, nullptr);
        gemm_kernel<<<dim3(D / 64, S / 64), 256, 0, stream>>>(A2, DS, w_bs, D, PS, D, S, D, DS, nullptr, nullptr);
        merge_kernel<<<S * D / 256, 256, 0, stream>>>(PA, PS, proj, b_gate, Mg);
        gemm_kernel<<<dim3(D / 64, S / 64), 256, 0, stream>>>(Mg, D, w_out, D, O, D, S, D, D, nullptr, nullptr);
        final_kernel<<<S / 4, 256, 0, stream>>>(xb, O, fgain, ob);
    }
}
```
